# Optimizing an MI355X kernel written in HIP

```python
import jax, jax.numpy as jnp
from jax import lax
import numpy as np

D_MODEL = 1024
BATCH = 2
SEQ = 8192
DEPTH = 1

N_ATTN_HEADS = 8
ATTN_HEAD_DIM = 64
ATTN_WIDTH = N_ATTN_HEADS * ATTN_HEAD_DIM
N_SGU_GROUPS = 8
SGU_WIDTH = D_MODEL // 2
SGU_GROUP_DIM = SGU_WIDTH // N_SGU_GROUPS
CHUNK = 128
Q_BLOCK = 128
D_FF = 4 * D_MODEL
N_BRANCH = 2
EPS = 1e-6
IN_SPLITS = (2 * SGU_WIDTH, ATTN_WIDTH, ATTN_WIDTH, ATTN_WIDTH, N_ATTN_HEADS, N_BRANCH * D_MODEL)
IN_WIDTH = sum(IN_SPLITS)
IN_OFFSETS = tuple(int(o) for o in np.cumsum(IN_SPLITS)[:-1])

kernel_name = "hybrid_gmlp_fox_gated_block"


def rmsnorm(x, g):
    x32 = x.astype(jnp.float32)
    y = x32 * lax.rsqrt(jnp.mean(x32 * x32, axis=-1, keepdims=True) + EPS)
    return y.astype(x.dtype) * g


def layernorm(x, g, b):
    x32 = x.astype(jnp.float32)
    mu = jnp.mean(x32, axis=-1, keepdims=True)
    xc = x32 - mu
    y = xc * lax.rsqrt(jnp.mean(xc * xc, axis=-1, keepdims=True) + EPS)
    return y.astype(x.dtype) * g + b


def chunked_sgu(z, g_sgu, b_sgu, w_spatial, b_spatial):
    B, S, _ = z.shape
    u, v = z[..., :SGU_WIDTH], z[..., SGU_WIDTH:]
    v = layernorm(v, g_sgu, b_sgu)
    vc = v.reshape(B, S // CHUNK, CHUNK, N_SGU_GROUPS, SGU_GROUP_DIM)
    causal = jnp.tril(jnp.ones((CHUNK, CHUNK), dtype=bool))
    ws = jnp.where(causal[None], w_spatial, jnp.zeros_like(w_spatial))
    s = jnp.einsum('gts,bcsgd->bctgd', ws, vc)
    s = s + b_spatial.T[None, None, :, :, None]
    return u * s.reshape(B, S, SGU_WIDTH)


def forgetting_attention(q, k, v, cum):
    B, H, S, d = q.shape
    nb = S // Q_BLOCK
    qb = q.reshape(B, H, nb, Q_BLOCK, d).transpose(2, 0, 1, 3, 4)
    cb = cum.reshape(B, H, nb, Q_BLOCK).transpose(2, 0, 1, 3)
    key_pos = jnp.arange(S)
    scale = d ** -0.5

    def one_block(args):
        q_blk, c_blk, i = args
        s = jnp.einsum('bhqd,bhkd->bhqk', q_blk, k).astype(jnp.float32) * scale
        s = s + c_blk[..., :, None] - cum[..., None, :]
        q_pos = i * Q_BLOCK + jnp.arange(Q_BLOCK)
        mask = key_pos[None, :] <= q_pos[:, None]
        s = jnp.where(mask, s, -jnp.inf)
        p = jax.nn.softmax(s, axis=-1)
        return jnp.einsum('bhqk,bhkd->bhqd', p.astype(v.dtype), v)

    out = lax.map(one_block, (qb, cb, jnp.arange(nb)))
    return out.transpose(1, 2, 0, 3, 4).reshape(B, H, S, d)


def setup_inputs(seed: int = 0) -> dict:
    key = jax.random.key(seed)
    ks = jax.random.split(key, 20)
    L = DEPTH

    def nrm(k, shape, scale):
        return jax.random.normal(k, shape, jnp.float32) * scale

    def gain(k, shape):
        return 1.0 + 0.05 * jax.random.normal(k, shape, jnp.float32)

    return {
        "x": jax.random.normal(ks[0], (BATCH, SEQ, D_MODEL), jnp.float32),
        "g_mix_pre": gain(ks[1], (L, D_MODEL)),
        "w_in": nrm(ks[2], (L, D_MODEL, IN_WIDTH), D_MODEL ** -0.5),
        "b_forget": 2.0 + 0.5 * jax.random.normal(ks[3], (L, N_ATTN_HEADS), jnp.float32),
        "g_sgu": gain(ks[4], (L, SGU_WIDTH)),
        "b_sgu": nrm(ks[5], (L, SGU_WIDTH), 0.02),
        "w_spatial": nrm(ks[6], (L, N_SGU_GROUPS, CHUNK, CHUNK), CHUNK ** -0.5),
        "b_spatial": 1.0 + 0.1 * jax.random.normal(ks[7], (L, N_SGU_GROUPS, CHUNK), jnp.float32),
        "w_branch_sgu": nrm(ks[8], (L, SGU_WIDTH, D_MODEL), SGU_WIDTH ** -0.5),
        "w_branch_attn": nrm(ks[9], (L, ATTN_WIDTH, D_MODEL), ATTN_WIDTH ** -0.5),
        "w_out": nrm(ks[10], (L, D_MODEL, D_MODEL), D_MODEL ** -0.5),
        "g_mix_post": gain(ks[11], (L, D_MODEL)),
        "g_ffn_pre": gain(ks[12], (L, D_MODEL)),
        "w_up": nrm(ks[13], (L, D_MODEL, D_FF), D_MODEL ** -0.5),
        "w_down": nrm(ks[14], (L, D_FF, D_MODEL), D_FF ** -0.5),
        "g_ffn_post": gain(ks[15], (L, D_MODEL)),
    }


def reference(x, g_mix_pre, w_in, b_forget, g_sgu, b_sgu, w_spatial, b_spatial,
              w_branch_sgu, w_branch_attn, w_out, g_mix_post, g_ffn_pre, w_up, w_down,
              g_ffn_post):
    B, S, _ = x.shape
    h = x
    for l in range(DEPTH):
        xn = rmsnorm(h, g_mix_pre[l])
        proj = xn @ w_in[l]
        z_sgu, q, k, v, f_logit, gate_logit = jnp.split(proj, IN_OFFSETS, axis=-1)

        y_sgu = chunked_sgu(jax.nn.gelu(z_sgu), g_sgu[l], b_sgu[l], w_spatial[l], b_spatial[l])

        def heads(t):
            return t.reshape(B, S, N_ATTN_HEADS, ATTN_HEAD_DIM).transpose(0, 2, 1, 3)
        log_f = jax.nn.log_sigmoid((f_logit + b_forget[l]).astype(jnp.float32))
        cum = jnp.cumsum(log_f, axis=1).transpose(0, 2, 1)
        y_attn = forgetting_attention(heads(q), heads(k), heads(v), cum)
        y_attn = y_attn.transpose(0, 2, 1, 3).reshape(B, S, ATTN_WIDTH)

        gates = jax.nn.sigmoid(gate_logit)
        merged = (gates[..., :D_MODEL] * (y_sgu @ w_branch_sgu[l])
                  + gates[..., D_MODEL:] * (y_attn @ w_branch_attn[l]))
        h = h + rmsnorm(merged @ w_out[l], g_mix_post[l])

        xn2 = rmsnorm(h, g_ffn_pre[l])
        hid = jnp.square(jax.nn.relu(xn2 @ w_up[l]))
        h = h + rmsnorm(hid @ w_down[l], g_ffn_post[l])
    return h
```

```cpp
#include <hip/hip_runtime.h>
#include <cstdint>
#include <cstdio>

typedef unsigned short bf16;
typedef unsigned u32x4 __attribute__((ext_vector_type(4)));
typedef float f32x4 __attribute__((ext_vector_type(4)));

constexpr int BATCH = 2, SEQ = 8192, DM = 1024, M = BATCH * SEQ, NH = 8, HD = 64, AW = 512, SW = 512, NG = 8, GD = 64, CH = 128, FF = 4096;
constexpr int INW = 4616, NP1 = 4608, FCOL = 2560;
constexpr float EPS = 1e-6f;
constexpr float LOG2E = 1.4426950408889634f;
constexpr float C2 = 0.125f * LOG2E;

constexpr size_t MiB = 1u << 20;
constexpr size_t WS_CTL = 0;
constexpr size_t WS_WIN = 1 * MiB, WS_WBS = 10 * MiB, WS_WBA = 11 * MiB, WS_WOUT = 12 * MiB, WS_WUP = 14 * MiB, WS_WDN = 22 * MiB, WS_WSP = 30 * MiB;
constexpr size_t WS_XS = 31 * MiB;
constexpr size_t WS_U = 33 * MiB, WS_VG = 49 * MiB, WS_Q = 65 * MiB, WS_K = 81 * MiB, WS_V = 97 * MiB, WS_G = 113 * MiB;
constexpr size_t WS_XN = 177 * MiB, WS_YS = 209 * MiB, WS_YA = 225 * MiB, WS_LOGF = 241 * MiB, WS_CUM = 242 * MiB, WS_END = 243 * MiB;
constexpr size_t WS_T = WS_U, WS_MERGED = WS_K, WS_HID = WS_U;
constexpr size_t WS_TMP4 = WS_G, WS_TMP6 = 161 * MiB;

__device__ __forceinline__ unsigned f2bf(float f) { unsigned u = __builtin_bit_cast(unsigned, f); return (u + 0x7fffu + ((u >> 16) & 1u)) >> 16; }
__device__ __forceinline__ float bf2f(unsigned h) { return __builtin_bit_cast(float, h << 16); }
__device__ __forceinline__ float wave_sum(float v) {
#pragma unroll
    for (int o = 1; o < 64; o <<= 1) v += __shfl_xor(v, o);
    return v;
}
__device__ __forceinline__ float gelu_tanh(float x) {
    const float u = 0.7978845608028654f * (x + 0.044715f * x * x * x);
    const float e = __expf(2.f * u);
    const float t = 1.f - 2.f / (1.f + e);
    return 0.5f * x * (1.f + t);
}
__device__ __forceinline__ float sigmoidf_(float x) { return 1.f / (1.f + __expf(-x)); }

__global__ void n_wt(const float* W, int K, int Nsrc, bf16* WT, int Ndst, int mode) {
    const size_t tot = (size_t)Ndst * K;
    for (size_t i = (size_t)blockIdx.x * blockDim.x + threadIdx.x; i < tot; i += (size_t)gridDim.x * blockDim.x) {
        const int n = (int)(i / K), k = (int)(i % K);
        const int src = (mode == 1 && n >= FCOL) ? n + 8 : n;
        WT[i] = (bf16)f2bf(W[(size_t)k * Nsrc + src]);
    }
}
__global__ void n_wsp(const float* W, bf16* WSP) {
    for (int i = blockIdx.x * blockDim.x + threadIdx.x; i < NG * CH * CH; i += gridDim.x * blockDim.x) {
        const int t = (i / CH) % CH, s = i % CH;
        WSP[i] = (bf16)(s <= t ? f2bf(W[i]) : 0u);
    }
}
__global__ void n_rms_in(const float* x, const float* g, const float* w_in, const float* b_forget, bf16* XN, float* LOGF) {
    const int lane = threadIdx.x & 63, gw = (blockIdx.x * blockDim.x + threadIdx.x) >> 6, NGW = (gridDim.x * blockDim.x) >> 6;
    for (int m = gw; m < M; m += NGW) {
        const f32x4* xr = (const f32x4*)(x + (size_t)m * DM) + lane;
        f32x4 v[4]; float s = 0.f;
#pragma unroll
        for (int j = 0; j < 4; ++j) { v[j] = xr[64 * j]; s += (v[j].x * v[j].x + v[j].y * v[j].y) + (v[j].z * v[j].z + v[j].w * v[j].w); }
        const float rstd = 1.f / sqrtf(wave_sum(s) * (1.f / DM) + EPS);
        float fl[8];
#pragma unroll
        for (int h = 0; h < 8; ++h) fl[h] = 0.f;
#pragma unroll
        for (int j = 0; j < 4; ++j) {
            const f32x4 gg = ((const f32x4*)g)[64 * j + lane];
            v[j] = v[j] * rstd * gg;
            unsigned long long o = (unsigned long long)(f2bf(v[j].x) | (f2bf(v[j].y) << 16)) | ((unsigned long long)(f2bf(v[j].z) | (f2bf(v[j].w) << 16)) << 32);
            ((unsigned long long*)(XN + (size_t)m * DM))[64 * j + lane] = o;
#pragma unroll
            for (int e = 0; e < 4; ++e) {
                const int i = (64 * j + lane) * 4 + e;
                const f32x4 w0 = *(const f32x4*)(w_in + (size_t)i * INW + FCOL), w1 = *(const f32x4*)(w_in + (size_t)i * INW + FCOL + 4);
                const float xv = v[j][e];
                fl[0] += xv * w0.x; fl[1] += xv * w0.y; fl[2] += xv * w0.z; fl[3] += xv * w0.w;
                fl[4] += xv * w1.x; fl[5] += xv * w1.y; fl[6] += xv * w1.z; fl[7] += xv * w1.w;
            }
        }
#pragma unroll
        for (int h = 0; h < 8; ++h) fl[h] = wave_sum(fl[h]);
        if (lane < 8) {
            float z = 0.f;
#pragma unroll
            for (int h = 0; h < 8; ++h) if (lane == h) z = fl[h];
            z += b_forget[lane];
            const float ls = fminf(z, 0.f) - log1pf(__expf(-fabsf(z)));
            LOGF[(size_t)m * 8 + lane] = ls;
        }
    }
}
__global__ void n_scan(const float* LOGF, float* CUM) {
    __shared__ float part[256];
    const int bh = blockIdx.x, b = bh / NH, h = bh % NH, tid = threadIdx.x;
    float loc[32]; float s = 0.f;
#pragma unroll
    for (int i = 0; i < 32; ++i) { loc[i] = LOGF[((size_t)b * SEQ + tid * 32 + i) * 8 + h]; s += loc[i]; }
    part[tid] = s; __syncthreads();
    if (tid == 0) { float a = 0.f; for (int i = 0; i < 256; ++i) { const float t = part[i]; part[i] = a; a += t; } }
    __syncthreads();
    float a = part[tid];
#pragma unroll
    for (int i = 0; i < 32; ++i) { a += loc[i]; CUM[(size_t)bh * SEQ + tid * 32 + i] = a; }
}

template <class Epi>
__global__ void __launch_bounds__(256) n_gemm(const bf16* A, const bf16* Bt, int K, Epi E) {
    __shared__ float As[16][132], Bs[16][132];
    const int tm = blockIdx.y * 128, tn = blockIdx.x * 128, tid = threadIdx.x, tx = tid & 15, ty = tid >> 4;
    float acc[8][8];
#pragma unroll
    for (int i = 0; i < 8; ++i)
#pragma unroll
        for (int j = 0; j < 8; ++j) acc[i][j] = 0.f;
    const int lr = tid >> 1, lk = (tid & 1) * 8;
    for (int k0 = 0; k0 < K; k0 += 16) {
        const u32x4 a = *(const u32x4*)(A + (size_t)(tm + lr) * K + k0 + lk), b = *(const u32x4*)(Bt + (size_t)(tn + lr) * K + k0 + lk);
#pragma unroll
        for (int j = 0; j < 4; ++j) {
            As[lk + 2 * j][lr] = bf2f(a[j] & 0xffffu); As[lk + 2 * j + 1][lr] = bf2f(a[j] >> 16);
            Bs[lk + 2 * j][lr] = bf2f(b[j] & 0xffffu); Bs[lk + 2 * j + 1][lr] = bf2f(b[j] >> 16);
        }
        __syncthreads();
#pragma unroll
        for (int kk = 0; kk < 16; ++kk) {
            float av[8], bv[8];
#pragma unroll
            for (int i = 0; i < 8; ++i) { av[i] = As[kk][ty * 8 + i]; bv[i] = Bs[kk][tx * 8 + i]; }
#pragma unroll
            for (int i = 0; i < 8; ++i)
#pragma unroll
                for (int j = 0; j < 8; ++j) acc[i][j] += av[i] * bv[j];
        }
        __syncthreads();
    }
#pragma unroll
    for (int i = 0; i < 8; ++i)
#pragma unroll
        for (int j = 0; j < 8; ++j) E(tm + ty * 8 + i, tn + tx * 8 + j, acc[i][j]);
}
struct EpiP1 { bf16 *U, *VG, *Q, *K, *V, *G;
    __device__ void operator()(int m, int n, float a) const {
        if (n < 512) U[(size_t)m * 512 + n] = (bf16)f2bf(gelu_tanh(a));
        else if (n < 1024) VG[(size_t)m * 512 + n - 512] = (bf16)f2bf(gelu_tanh(a));
        else if (n < 1536) Q[(size_t)m * 512 + n - 1024] = (bf16)f2bf(a * C2);
        else if (n < 2048) K[(size_t)m * 512 + n - 1536] = (bf16)f2bf(a);
        else if (n < 2560) V[(size_t)m * 512 + n - 2048] = (bf16)f2bf(a);
        else G[(size_t)m * 2048 + n - 2560] = (bf16)f2bf(sigmoidf_(a));
    } };
struct EpiP3a { const bf16* G; bf16* T;
    __device__ void operator()(int m, int n, float a) const { T[(size_t)m * DM + n] = (bf16)f2bf(bf2f(G[(size_t)m * 2048 + n]) * a); } };
struct EpiP3b { const bf16* G; const bf16* T; bf16* MG;
    __device__ void operator()(int m, int n, float a) const { MG[(size_t)m * DM + n] = (bf16)f2bf(bf2f(T[(size_t)m * DM + n]) + bf2f(G[(size_t)m * 2048 + 1024 + n]) * a); } };
struct EpiF32 { float* C;
    __device__ void operator()(int m, int n, float a) const { C[(size_t)m * DM + n] = a; } };
struct EpiP5 { bf16* H;
    __device__ void operator()(int m, int n, float a) const { const float r = fmaxf(a, 0.f); H[(size_t)m * FF + n] = (bf16)f2bf(r * r); } };

__global__ void __launch_bounds__(256) n_sgu(const bf16* U, const bf16* VG, const bf16* WSP, const float* g_sgu, const float* b_sgu, const float* b_spatial, bf16* YS) {
    __shared__ float vn[CH][GD + 1]; __shared__ float mean_s[CH], rstd_s[CH]; __shared__ float red[256];
    const int blk = blockIdx.x, g = blk % NG, c = (blk / NG) % (SEQ / CH), b = blk / (NG * (SEQ / CH)), tid = threadIdx.x;
    const size_t r0 = (size_t)b * SEQ + (size_t)c * CH;
    {
        const int t = tid >> 1, hf = tid & 1; const bf16* row = VG + (r0 + t) * SW + hf * 256;
        float s = 0.f; for (int i = 0; i < 256; ++i) s += bf2f(row[i]);
        red[tid] = s; __syncthreads();
        const float mean = (red[t * 2] + red[t * 2 + 1]) * (1.f / SW); __syncthreads();
        float q = 0.f; for (int i = 0; i < 256; ++i) { const float d = bf2f(row[i]) - mean; q += d * d; }
        red[tid] = q; __syncthreads();
        if (hf == 0) { mean_s[t] = mean; rstd_s[t] = 1.f / sqrtf((red[t * 2] + red[t * 2 + 1]) * (1.f / SW) + EPS); }
        __syncthreads();
    }
    for (int i = tid; i < CH * GD; i += 256) { const int s = i / GD, d = i % GD, f = g * GD + d;
        const float v = (bf2f(VG[(r0 + s) * SW + f]) - mean_s[s]) * rstd_s[s] * g_sgu[f] + b_sgu[f];
        vn[s][d] = bf2f(f2bf(v)); }
    __syncthreads();
    const int d = tid & 63;
    for (int t = tid >> 6; t < CH; t += 4) {
        float a = 0.f; const bf16* wr = WSP + ((size_t)g * CH + t) * CH;
        for (int s = 0; s <= t; ++s) a += bf2f(wr[s]) * vn[s][d];
        a += b_spatial[g * CH + t];
        YS[(r0 + t) * SW + g * GD + d] = (bf16)f2bf(bf2f(U[(r0 + t) * SW + g * GD + d]) * a);
    }
}

__global__ void __launch_bounds__(256) n_attn(const bf16* Q, const bf16* Kt, const bf16* V, const float* CUM, bf16* YA) {
    __shared__ float Ks[64][64], Vs[64][64], cs[64];
    const int qb = blockIdx.x % 32, bh = blockIdx.x / 32, b = bh / NH, h = bh % NH, tid = threadIdx.x;
    const int t = qb * 256 + tid; const size_t rb = (size_t)b * SEQ;
    float q[64], o[64];
#pragma unroll
    for (int d = 0; d < 64; ++d) { q[d] = bf2f(Q[(rb + t) * AW + h * HD + d]); o[d] = 0.f; }
    const float ct = CUM[(size_t)bh * SEQ + t] * LOG2E;
    float mx = -INFINITY, l = 0.f;
    const int nkt = (qb * 256 + 256) / 64;
    for (int kt = 0; kt < nkt; ++kt) {
        __syncthreads();
        for (int i = tid; i < 64 * 64; i += 256) { const int j = i >> 6, d = i & 63; Ks[j][d] = bf2f(Kt[(rb + kt * 64 + j) * AW + h * HD + d]); Vs[j][d] = bf2f(V[(rb + kt * 64 + j) * AW + h * HD + d]); }
        if (tid < 64) cs[tid] = CUM[(size_t)bh * SEQ + kt * 64 + tid] * LOG2E;
        __syncthreads();
        for (int j = 0; j < 64; ++j) {
            const int s = kt * 64 + j;
            if (s <= t) {
                float x = 0.f;
#pragma unroll
                for (int d = 0; d < 64; ++d) x += q[d] * Ks[j][d];
                x += ct - cs[j];
                const float mn = fmaxf(mx, x), corr = exp2f(mx - mn), p = exp2f(x - mn);
                l = l * corr + p; mx = mn;
                const float pb = bf2f(f2bf(p));
#pragma unroll
                for (int d = 0; d < 64; ++d) o[d] = o[d] * corr + pb * Vs[j][d];
            }
        }
    }
    const float il = 1.f / l;
#pragma unroll
    for (int d = 0; d < 64; ++d) YA[(rb + t) * AW + h * HD + d] = (bf16)f2bf(o[d] * il);
}

__global__ void n_row_epi(const float* base, const float* Y, const float* g1, const float* g2, float* out, bf16* XN2) {
    const int lane = threadIdx.x & 63, gw = (blockIdx.x * blockDim.x + threadIdx.x) >> 6, NGW = (gridDim.x * blockDim.x) >> 6;
    for (int m = gw; m < M; m += NGW) {
        f32x4 y[4], hv[4]; float s = 0.f;
#pragma unroll
        for (int j = 0; j < 4; ++j) { y[j] = ((const f32x4*)(Y + (size_t)m * DM))[64 * j + lane]; s += (y[j].x * y[j].x + y[j].y * y[j].y) + (y[j].z * y[j].z + y[j].w * y[j].w); }
        const float rstd = 1.f / sqrtf(wave_sum(s) * (1.f / DM) + EPS); float s2 = 0.f;
#pragma unroll
        for (int j = 0; j < 4; ++j) { const f32x4 gg = ((const f32x4*)g1)[64 * j + lane]; const f32x4 bs = ((const f32x4*)(base + (size_t)m * DM))[64 * j + lane];
            hv[j] = bs + y[j] * rstd * gg; ((f32x4*)(out + (size_t)m * DM))[64 * j + lane] = hv[j];
            s2 += (hv[j].x * hv[j].x + hv[j].y * hv[j].y) + (hv[j].z * hv[j].z + hv[j].w * hv[j].w); }
        if (XN2) {
            const float r2 = 1.f / sqrtf(wave_sum(s2) * (1.f / DM) + EPS);
#pragma unroll
            for (int j = 0; j < 4; ++j) { const f32x4 gg = ((const f32x4*)g2)[64 * j + lane]; const f32x4 v = hv[j] * r2 * gg;
                ((unsigned long long*)(XN2 + (size_t)m * DM))[64 * j + lane] = (unsigned long long)(f2bf(v.x) | (f2bf(v.y) << 16)) | ((unsigned long long)(f2bf(v.z) | (f2bf(v.w) << 16)) << 32); }
        }
    }
}

extern "C" void kernel_launch(void* const* d_in, const int* in_sizes, int n_in, void* d_out, int out_size, void* d_ws, size_t ws_size, hipStream_t stream) {
    if (n_in != 16 || ws_size < WS_END) { fprintf(stderr, "kernel_launch: unexpected n_in %d / ws %zu\n", n_in, ws_size); return; }
    const float* x = (const float*)d_in[0]; const float* g_mix_pre = (const float*)d_in[1]; const float* w_in = (const float*)d_in[2]; const float* b_forget = (const float*)d_in[3];
    const float* g_sgu = (const float*)d_in[4]; const float* b_sgu = (const float*)d_in[5]; const float* w_spatial = (const float*)d_in[6]; const float* b_spatial = (const float*)d_in[7];
    const float* w_bs = (const float*)d_in[8]; const float* w_ba = (const float*)d_in[9]; const float* w_out = (const float*)d_in[10]; const float* g_mix_post = (const float*)d_in[11];
    const float* g_ffn_pre = (const float*)d_in[12]; const float* w_up = (const float*)d_in[13]; const float* w_down = (const float*)d_in[14]; const float* g_ffn_post = (const float*)d_in[15];
    unsigned char* ws = (unsigned char*)d_ws; float* out = (float*)d_out;
    bf16 *WIN = (bf16*)(ws + WS_WIN), *WBS = (bf16*)(ws + WS_WBS), *WBA = (bf16*)(ws + WS_WBA), *WOUT = (bf16*)(ws + WS_WOUT), *WUP = (bf16*)(ws + WS_WUP), *WDN = (bf16*)(ws + WS_WDN), *WSP = (bf16*)(ws + WS_WSP);
    bf16 *U = (bf16*)(ws + WS_U), *VG = (bf16*)(ws + WS_VG), *Q = (bf16*)(ws + WS_Q), *K = (bf16*)(ws + WS_K), *V = (bf16*)(ws + WS_V), *G = (bf16*)(ws + WS_G);
    bf16 *XN = (bf16*)(ws + WS_XN), *YS = (bf16*)(ws + WS_YS), *YA = (bf16*)(ws + WS_YA), *T = (bf16*)(ws + WS_T), *MG = (bf16*)(ws + WS_MERGED), *HID = (bf16*)(ws + WS_HID);
    float *LOGF = (float*)(ws + WS_LOGF), *CUM = (float*)(ws + WS_CUM), *TMP4 = (float*)(ws + WS_TMP4), *TMP6 = (float*)(ws + WS_TMP6);
    n_wt<<<2048, 256, 0, stream>>>(w_in, DM, INW, WIN, NP1, 1);
    n_wt<<<512, 256, 0, stream>>>(w_bs, SW, DM, WBS, DM, 0);
    n_wt<<<512, 256, 0, stream>>>(w_ba, AW, DM, WBA, DM, 0);
    n_wt<<<1024, 256, 0, stream>>>(w_out, DM, DM, WOUT, DM, 0);
    n_wt<<<2048, 256, 0, stream>>>(w_up, DM, FF, WUP, FF, 0);
    n_wt<<<2048, 256, 0, stream>>>(w_down, FF, DM, WDN, DM, 0);
    n_wsp<<<512, 256, 0, stream>>>(w_spatial, WSP);
    n_rms_in<<<1024, 256, 0, stream>>>(x, g_mix_pre, w_in, b_forget, XN, LOGF);
    n_scan<<<BATCH * NH, 256, 0, stream>>>(LOGF, CUM);
    n_gemm<EpiP1><<<dim3(NP1 / 128, M / 128), 256, 0, stream>>>(XN, WIN, DM, EpiP1{U, VG, Q, K, V, G});
    n_sgu<<<BATCH * (SEQ / CH) * NG, 256, 0, stream>>>(U, VG, WSP, g_sgu, b_sgu, b_spatial, YS);
    n_attn<<<BATCH * NH * 32, 256, 0, stream>>>(Q, K, V, CUM, YA);
    n_gemm<EpiP3a><<<dim3(DM / 128, M / 128), 256, 0, stream>>>(YS, WBS, SW, EpiP3a{G, T});
    n_gemm<EpiP3b><<<dim3(DM / 128, M / 128), 256, 0, stream>>>(YA, WBA, AW, EpiP3b{G, T, MG});
    n_gemm<EpiF32><<<dim3(DM / 128, M / 128), 256, 0, stream>>>(MG, WOUT, DM, EpiF32{TMP4});
    n_row_epi<<<1024, 256, 0, stream>>>(x, TMP4, g_mix_post, g_ffn_pre, out, XN);
    n_gemm<EpiP5><<<dim3(FF / 128, M / 128), 256, 0, stream>>>(XN, WUP, DM, EpiP5{HID});
    n_gemm<EpiF32><<<dim3(DM / 128, M / 128), 256, 0, stream>>>(HID, WDN, FF, EpiF32{TMP6});
    n_row_epi<<<1024, 256, 0, stream>>>(out, TMP6, g_ffn_post, nullptr, out, nullptr);
}
```
